# Optimizing an MI355X kernel written in HIP

```python
import jax, jax.numpy as jnp
from jax import lax
import numpy as np

D_MODEL = 1024
BATCH = 32
SEQ = 256
DEPTH = 2
DEC_BATCH = 4
DEC_SEQ = 1024
PAST_LEN = 512

GRID_W = 64
N_EVEN = (DEPTH + 1) // 2
N_ODD = DEPTH // 2
N_MOD = 9
D_FF = ((8 * D_MODEL // 3 + 127) // 128) * 128
D_CONV = D_MODEL // 2
CONV_WIDTH = 31
D_POOL = D_MODEL // 2
POOL_WINDOWS = (2, 4, 8, 16)
POOL_GROUP = D_POOL // len(POOL_WINDOWS)
N_HEADS_C = 8
QK_NOPE = 128
QK_ROPE = 64
V_DIM = 128
KV_LORA = D_MODEL // 4
Q_LORA = 3 * D_MODEL // 8
ROPE_AXIS_PAIRS = QK_ROPE // 4
ROPE_BASE = 10000.0
Q_BLOCK = 128
ALPHA = (2 * DEPTH) ** 0.25
BETA = (8 * DEPTH) ** -0.25
LN_EPS = 1e-5
RMS_EPS = 1e-6

kernel_name = 'hybrid_conv_pool_mla_prefix_dit'


def layer_norm(x, g, b):
    xf = x.astype(jnp.float32)
    mu = jnp.mean(xf, -1, keepdims=True)
    var = jnp.mean(jnp.square(xf - mu), -1, keepdims=True)
    return ((xf - mu) * lax.rsqrt(var + LN_EPS)).astype(x.dtype) * g + b


def rms_norm(x, g):
    xf = x.astype(jnp.float32)
    return (xf * lax.rsqrt(jnp.mean(xf * xf, -1, keepdims=True) + RMS_EPS)).astype(x.dtype) * g


def modulate(x, shift, scale):
    return x * (1 + scale) + shift


def swiglu(x, w1, w3, w2):
    return (jax.nn.silu(x @ w1) * (x @ w3)) @ w2


def ffn_sub(x, shift, scale, gate, g, b, w1, w3, w2):
    h = modulate(x, shift, scale)
    return layer_norm(ALPHA * x + 0.5 * gate * swiglu(h, w1, w3, w2), g, b)


def conv_module(u, gate, conv_w, conv_b, norm_g, norm_b):
    h = u * jax.nn.sigmoid(gate)
    pad = CONV_WIDTH // 2
    h = lax.conv_general_dilated(h, conv_w[:, None, :], window_strides=(1,), padding=((pad, pad),),
                                 dimension_numbers=('NWC', 'WIO', 'NWC'),
                                 feature_group_count=h.shape[-1]) + conv_b
    return jax.nn.silu(layer_norm(h, norm_g, norm_b))


def pool_module(h, pool_w, pool_scale):
    n = h.shape[1]
    t = jnp.arange(n)
    cs = jnp.pad(jnp.cumsum(h.astype(jnp.float32), axis=1), ((0, 0), (1, 0), (0, 0)))
    outs = []
    for gi, w in enumerate(POOL_WINDOWS):
        left = w // 2
        right = w - 1 - left
        lo = jnp.clip(t - left, 0, n - 1)
        hi = jnp.clip(t + right, 0, n - 1)
        sl = slice(gi * POOL_GROUP, (gi + 1) * POOL_GROUP)
        cg = cs[..., sl]
        mean = (jnp.take(cg, hi + 1, axis=1) - jnp.take(cg, lo, axis=1)) / (hi - lo + 1).astype(jnp.float32)[:, None]
        outs.append((mean.astype(h.dtype) - h[..., sl]) @ pool_w[gi])
    return jnp.concatenate(outs, -1) * pool_scale


def conv_pool_mixer(x, w_in, conv_w, conv_b, norm_g, norm_b, pool_w, pool_scale, w_out):
    proj = x @ w_in
    u = proj[..., :D_CONV]
    gate = proj[..., D_CONV:2 * D_CONV]
    hp = proj[..., 2 * D_CONV:]
    a = conv_module(u, gate, conv_w, conv_b, norm_g, norm_b)
    b = pool_module(hp, pool_w, pool_scale)
    return jnp.concatenate([a, b], -1) @ w_out


def axial_angles(n):
    rows = n // GRID_W
    row = jnp.repeat(jnp.arange(rows), GRID_W)
    col = jnp.tile(jnp.arange(GRID_W), rows)
    inv = ROPE_BASE ** (-jnp.arange(ROPE_AXIS_PAIRS, dtype=jnp.float32) / ROPE_AXIS_PAIRS)
    ang = jnp.concatenate([row[:, None] * inv, col[:, None] * inv], -1)
    return jnp.cos(ang), jnp.sin(ang)


def apply_rope_2d(x, cos, sin):
    n = cos.shape[0]
    xs = x.reshape(x.shape[:-1] + (2, 2, ROPE_AXIS_PAIRS))
    x1, x2 = xs[..., 0, :], xs[..., 1, :]
    bshape = (n,) + (1,) * (x.ndim - 3) + (2, ROPE_AXIS_PAIRS)
    c = cos.reshape(bshape)
    s = sin.reshape(bshape)
    out = jnp.stack([x1 * c - x2 * s, x1 * s + x2 * c], axis=-2)
    return out.reshape(x.shape).astype(x.dtype)


def mla_q(x, w_dq, q_norm_g, w_uq):
    q = rms_norm(x @ w_dq, q_norm_g) @ w_uq
    q = q.reshape(x.shape[:2] + (N_HEADS_C, QK_NOPE + QK_ROPE))
    return q[..., :QK_NOPE], q[..., QK_NOPE:]


def mla_compress_kv(x, w_dkv, kv_norm_g):
    kv = x @ w_dkv
    return rms_norm(kv[..., :KV_LORA], kv_norm_g), kv[..., KV_LORA:]


def mla_expand(c_kv, w_ukv):
    kv = (c_kv @ w_ukv).reshape(c_kv.shape[:2] + (N_HEADS_C, QK_NOPE + V_DIM))
    return kv[..., :QK_NOPE], kv[..., QK_NOPE:]


def mla_attend(q_nope, q_rope, k_nope, k_rope, v):
    b, n = q_nope.shape[:2]
    qb = min(Q_BLOCK, n)
    nb = n // qb
    scale = (QK_NOPE + QK_ROPE) ** -0.5

    def block(qs):
        qn, qr = qs
        s = (jnp.einsum('bqhd,bkhd->bhqk', qn, k_nope, preferred_element_type=jnp.float32)
             + jnp.einsum('bqhr,bkr->bhqk', qr, k_rope, preferred_element_type=jnp.float32))
        p = jax.nn.softmax(s * scale, axis=-1).astype(v.dtype)
        return jnp.einsum('bhqk,bkhd->bqhd', p, v)

    def to_blocks(a):
        return jnp.moveaxis(a.reshape((b, nb, qb) + a.shape[2:]), 1, 0)

    out = lax.map(block, (to_blocks(q_nope), to_blocks(q_rope)))
    return jnp.moveaxis(out, 0, 1).reshape(b, n, N_HEADS_C * V_DIM)


def setup_inputs(seed: int = 0) -> dict:
    key = jax.random.key(seed)
    ks = jax.random.split(key, 32)

    def nrm(k, shape, scale):
        return jax.random.normal(k, shape, jnp.float32) * scale

    d = D_MODEL
    return {
        'x_prompt': nrm(ks[0], (BATCH, SEQ, d), 1.0),
        'x_sample': nrm(ks[1], (DEC_BATCH, DEC_SEQ, d), 1.0),
        'cache_mla_ckv': nrm(ks[2], (DEC_BATCH, N_ODD, PAST_LEN, KV_LORA), 1.0),
        'cache_mla_krope': nrm(ks[3], (DEC_BATCH, N_ODD, PAST_LEN, QK_ROPE), 1.0),
        'c': nrm(ks[4], (DEC_BATCH, d), 1.0),
        'c_ctx': nrm(ks[5], (d,), 1.0),
        'w_ada': nrm(ks[6], (DEPTH, d, N_MOD * d), d ** -0.5),
        'b_ada': nrm(ks[7], (DEPTH, N_MOD * d), 0.01),
        'ln_g': 1.0 + nrm(ks[8], (DEPTH, 3, d), 0.05),
        'ln_b': nrm(ks[9], (DEPTH, 3, d), 0.02),
        'ffn_w1': nrm(ks[10], (DEPTH, 2, d, D_FF), d ** -0.5),
        'ffn_w3': nrm(ks[11], (DEPTH, 2, d, D_FF), d ** -0.5),
        'ffn_w2': nrm(ks[12], (DEPTH, 2, D_FF, d), BETA * D_FF ** -0.5),
        'cp_w_in': nrm(ks[13], (N_EVEN, d, 2 * D_CONV + D_POOL), d ** -0.5),
        'conv_w': nrm(ks[14], (N_EVEN, CONV_WIDTH, D_CONV), CONV_WIDTH ** -0.5),
        'conv_b': nrm(ks[15], (N_EVEN, D_CONV), 0.02),
        'conv_norm_g': 1.0 + nrm(ks[16], (N_EVEN, D_CONV), 0.05),
        'conv_norm_b': nrm(ks[17], (N_EVEN, D_CONV), 0.02),
        'pool_w': nrm(ks[18], (N_EVEN, len(POOL_WINDOWS), POOL_GROUP, POOL_GROUP), POOL_GROUP ** -0.5),
        'pool_scale': 1.0 + nrm(ks[19], (N_EVEN, D_POOL), 0.1),
        'cp_w_out': nrm(ks[20], (N_EVEN, D_CONV + D_POOL, d), BETA * (D_CONV + D_POOL) ** -0.5),
        'mla_w_dq': nrm(ks[21], (N_ODD, d, Q_LORA), d ** -0.5),
        'mla_q_norm_g': 1.0 + nrm(ks[22], (N_ODD, Q_LORA), 0.05),
        'mla_w_uq': nrm(ks[23], (N_ODD, Q_LORA, N_HEADS_C * (QK_NOPE + QK_ROPE)), Q_LORA ** -0.5),
        'mla_w_dkv': nrm(ks[24], (N_ODD, d, KV_LORA + QK_ROPE), d ** -0.5),
        'mla_kv_norm_g': 1.0 + nrm(ks[25], (N_ODD, KV_LORA), 0.05),
        'mla_w_ukv': nrm(ks[26], (N_ODD, KV_LORA, N_HEADS_C * (QK_NOPE + V_DIM)), KV_LORA ** -0.5),
        'mla_w_o': nrm(ks[27], (N_ODD, N_HEADS_C * V_DIM, d), BETA * (N_HEADS_C * V_DIM) ** -0.5),
    }


def reference(x_prompt, x_sample, cache_mla_ckv, cache_mla_krope, c, c_ctx,
              w_ada, b_ada, ln_g, ln_b, ffn_w1, ffn_w3, ffn_w2,
              cp_w_in, conv_w, conv_b, conv_norm_g, conv_norm_b, pool_w, pool_scale, cp_w_out,
              mla_w_dq, mla_q_norm_g, mla_w_uq, mla_w_dkv, mla_kv_norm_g, mla_w_ukv, mla_w_o):
    ada_ctx = jnp.einsum('d,lde->le', jax.nn.silu(c_ctx), w_ada) + b_ada
    ada_lat = jnp.einsum('bd,lde->lbe', jax.nn.silu(c), w_ada) + b_ada[:, None, :]
    cos, sin = axial_angles(x_sample.shape[1])

    xp, xs = x_prompt, x_sample
    new_ckv, new_krope = [], []
    for i in range(DEPTH):
        mp = jnp.split(ada_ctx[i][None, None, :], N_MOD, axis=-1)
        ms = jnp.split(ada_lat[i][:, None, :], N_MOD, axis=-1)
        xp = ffn_sub(xp, mp[0], mp[1], mp[2], ln_g[i, 0], ln_b[i, 0], ffn_w1[i, 0], ffn_w3[i, 0], ffn_w2[i, 0])
        xs = ffn_sub(xs, ms[0], ms[1], ms[2], ln_g[i, 0], ln_b[i, 0], ffn_w1[i, 0], ffn_w3[i, 0], ffn_w2[i, 0])
        hp = modulate(xp, mp[3], mp[4])
        hs = modulate(xs, ms[3], ms[4])
        j = i // 2
        if i % 2 == 0:
            yp = conv_pool_mixer(hp, cp_w_in[j], conv_w[j], conv_b[j], conv_norm_g[j], conv_norm_b[j],
                                 pool_w[j], pool_scale[j], cp_w_out[j])
            ys = conv_pool_mixer(hs, cp_w_in[j], conv_w[j], conv_b[j], conv_norm_g[j], conv_norm_b[j],
                                 pool_w[j], pool_scale[j], cp_w_out[j])
        else:
            ckv_p, kr_p = mla_compress_kv(hp, mla_w_dkv[j], mla_kv_norm_g[j])
            new_ckv.append(ckv_p)
            new_krope.append(kr_p)
            qn_p, qr_p = mla_q(hp, mla_w_dq[j], mla_q_norm_g[j], mla_w_uq[j])
            kn_p, v_p = mla_expand(ckv_p, mla_w_ukv[j])
            yp = mla_attend(qn_p, qr_p, kn_p, kr_p, v_p) @ mla_w_o[j]
            ckv_s, kr_s = mla_compress_kv(hs, mla_w_dkv[j], mla_kv_norm_g[j])
            kr_s = apply_rope_2d(kr_s, cos, sin)
            qn_s, qr_s = mla_q(hs, mla_w_dq[j], mla_q_norm_g[j], mla_w_uq[j])
            qr_s = apply_rope_2d(qr_s, cos, sin)
            ckv_all = jnp.concatenate([ckv_s, cache_mla_ckv[:, j]], axis=1)
            kr_all = jnp.concatenate([kr_s, cache_mla_krope[:, j]], axis=1)
            kn_s, v_s = mla_expand(ckv_all, mla_w_ukv[j])
            ys = mla_attend(qn_s, qr_s, kn_s, kr_all, v_s) @ mla_w_o[j]
        xp = layer_norm(ALPHA * xp + mp[5] * yp, ln_g[i, 1], ln_b[i, 1])
        xs = layer_norm(ALPHA * xs + ms[5] * ys, ln_g[i, 1], ln_b[i, 1])
        xp = ffn_sub(xp, mp[6], mp[7], mp[8], ln_g[i, 2], ln_b[i, 2], ffn_w1[i, 1], ffn_w3[i, 1], ffn_w2[i, 1])
        xs = ffn_sub(xs, ms[6], ms[7], ms[8], ln_g[i, 2], ln_b[i, 2], ffn_w1[i, 1], ffn_w3[i, 1], ffn_w2[i, 1])

    new_mla_ckv = jnp.stack(new_ckv, axis=1)
    new_mla_krope = jnp.stack(new_krope, axis=1)
    return (xp, xs, new_mla_ckv, new_mla_krope)
```

```cpp
#include <hip/hip_runtime.h>
#include <hip/hip_bf16.h>
#include <cstdio>
#include <cstdint>

#ifndef MK_MULTI
#define MK_MULTI 1
#endif

namespace pg8 {
#define PG8_LAS __attribute__((address_space(3)))
typedef unsigned short bf16_t;
typedef short bf16x8 __attribute__((ext_vector_type(8)));
typedef float f32x4 __attribute__((ext_vector_type(4)));
typedef unsigned u32x4 __attribute__((ext_vector_type(4)));
constexpr int BM = 256, BK = 64, HALF = 128, HTB = HALF * BK * 2  , STAGE_BYTES = 8 * HTB, NXCD = 8, WGM = 8;

__host__ __device__ __forceinline__ int lds_byte(int r, int c) { const int st = (r >> 4) * 2 + (c >> 5), rr = r & 15, cc = c & 31, ob = rr * 64 + cc * 2; return st * 1024 + (ob ^ (((ob >> 9) & 1) << 5)); }
__host__ __device__ __forceinline__ void stage_rc(int b, int& R, int& C) { const int st = b / 1024, sb = b % 1024, swz = sb ^ (((sb >> 9) & 1) << 5); R = (st >> 1) * 16 + swz / 64; C = (st & 1) * 32 + (swz % 64) / 2; }
__host__ __device__ __forceinline__ int perm32(int rho) { const int n = rho >> 4, i = rho & 15; return 8 * (i >> 2) + 4 * n + (i & 3); }

struct Unit { int pm, pn; };
struct Gemm { const bf16_t* A; const bf16_t* Bt; int M, N, K; };

struct StaticOrder {
    int nM, nN, nwg, G, c;
    __host__ __device__ void init(int M, int N, int G_, int c_) { nM = M / BM; nN = N / BM; nwg = nM * nN; G = G_; c = c_; }
    __host__ __device__ bool next(int i, Unit& u) const {
        const long L = (long)i * G + c; if (L >= nwg) return false;
        int wgid = (int)L; { const int q = nwg / NXCD, r = nwg % NXCD, xcd = wgid % NXCD, off = wgid / NXCD; wgid = (xcd < r ? xcd * (q + 1) : r * (q + 1) + (xcd - r) * q) + off; }
        const int nig = WGM * nN, gid = wgid / nig, fm = gid * WGM, gsz = (nM - fm) < WGM ? (nM - fm) : WGM;
        u.pm = fm + ((wgid % nig) % gsz); u.pn = (wgid % nig) / gsz; return true;
    }
    __device__ __forceinline__ void a_ready(const Unit&) const {}
    __device__ __forceinline__ void done(const Unit&) const {}
};

__device__ __forceinline__ unsigned cvt_pk_bf16(float lo, float hi) { unsigned r; asm volatile("v_cvt_pk_bf16_f32 %0, %1, %2" : "=v"(r) : "v"(lo), "v"(hi)); return r; }
typedef unsigned u32x2 __attribute__((ext_vector_type(2)));
__device__ __forceinline__ float sigmoid_f(float v) { return __builtin_amdgcn_rcpf(1.0f + __builtin_amdgcn_exp2f(-1.4426950408889634f * v)); }

struct EpiB {
    static constexpr bool PERM = true, AFTER_DRAIN = false;
    int mode; bf16_t* O0; bf16_t* O1; int ld0, ld1;
    __device__ __forceinline__ void operator()(const f32x4 (&acc)[2][2][4][2], const Unit& u, int wr, int wc, int fr, int fq) const {
        const int row0 = u.pm * BM + wr * 64 + fr;
        if (mode == 2 || (mode == 1 && u.pn >= 4)) {
            bf16_t* base = (mode == 2) ? O0 : O1; const int ld = (mode == 2) ? ld0 : ld1; const int col0 = ((mode == 2) ? u.pn : (u.pn - 4)) * BM + wc * 32 + 8 * fq;
#pragma unroll
            for (int ai = 0; ai < 2; ++ai)
#pragma unroll
                for (int m = 0; m < 4; ++m) { bf16_t* rowp = base + (size_t)(row0 + ai * HALF + m * 16) * ld + col0;
#pragma unroll
                    for (int bj = 0; bj < 2; ++bj) { const f32x4 v0 = acc[ai][bj][m][0], v1 = acc[ai][bj][m][1];
                        u32x4 w; w.x = cvt_pk_bf16(v0[0], v0[1]); w.y = cvt_pk_bf16(v0[2], v0[3]); w.z = cvt_pk_bf16(v1[0], v1[1]); w.w = cvt_pk_bf16(v1[2], v1[3]);
                        *(u32x4*)(rowp + bj * HALF) = w; } }
        } else {
            const int col0 = u.pn * HALF + wc * 32 + 8 * fq;
#pragma unroll
            for (int ai = 0; ai < 2; ++ai)
#pragma unroll
                for (int m = 0; m < 4; ++m) { bf16_t* rowp = O0 + (size_t)(row0 + ai * HALF + m * 16) * ld0 + col0;
                    float r[8];
#pragma unroll
                    for (int n = 0; n < 2; ++n)
#pragma unroll
                        for (int j = 0; j < 4; ++j) { const float a = acc[ai][0][m][n][j], b = acc[ai][1][m][n][j];
                            r[n * 4 + j] = (mode == 0) ? (a * sigmoid_f(a)) * b : a * sigmoid_f(b); }
                    u32x4 w; w.x = cvt_pk_bf16(r[0], r[1]); w.y = cvt_pk_bf16(r[2], r[3]); w.z = cvt_pk_bf16(r[4], r[5]); w.w = cvt_pk_bf16(r[6], r[7]);
                    *(u32x4*)rowp = w; }
        }
    }
};

struct EpiF {
    static constexpr bool PERM = false, AFTER_DRAIN = false;
    int mode; float* C; int ldc;
    const float* xP; const float* xS; const float* ada_l; int gidx; float wgt, alpha;
    bf16_t* Qo; const float* rtab;
    __device__ __forceinline__ void operator()(const f32x4 (&acc)[2][2][4][2], const Unit& u, int wr, int wc, int fr, int fq) const {
        const int row0 = u.pm * BM + wr * 64 + fr, col0 = u.pn * BM + wc * 32 + 4 * fq;
        if (mode == 0) {
            const int g = u.pm < 32 ? 0 : 1 + ((u.pm - 32) >> 2);
            const float* gate = ada_l + (size_t)g * 9216 + gidx * 1024 + col0;
            f32x4 gv[2][2];
#pragma unroll
            for (int bj = 0; bj < 2; ++bj)
#pragma unroll
                for (int n = 0; n < 2; ++n) gv[bj][n] = *(const f32x4*)(gate + bj * HALF + n * 16) * wgt;
            const float* xb = u.pm < 32 ? xP : xS - (size_t)8192 * 1024;
#pragma unroll
            for (int ai = 0; ai < 2; ++ai)
#pragma unroll
                for (int m = 0; m < 4; ++m) { const size_t off = (size_t)(row0 + ai * HALF + m * 16) * 1024 + col0;
#pragma unroll
                    for (int bj = 0; bj < 2; ++bj)
#pragma unroll
                        for (int n = 0; n < 2; ++n) { const f32x4 xr = *(const f32x4*)(xb + off + bj * HALF + n * 16);
                            *(f32x4*)(C + off + bj * HALF + n * 16) = xr * alpha + gv[bj][n] * acc[ai][bj][m][n]; } }
        } else if (mode == 1) {
#pragma unroll
            for (int ai = 0; ai < 2; ++ai)
#pragma unroll
                for (int m = 0; m < 4; ++m) { float* rowp = C + (size_t)(row0 + ai * HALF + m * 16) * ldc + col0;
#pragma unroll
                    for (int bj = 0; bj < 2; ++bj)
#pragma unroll
                        for (int n = 0; n < 2; ++n) *(f32x4*)(rowp + bj * HALF + n * 16) = acc[ai][bj][m][n]; }
        } else {
            const bool lat = u.pm >= 32;
#pragma unroll
            for (int bj = 0; bj < 2; ++bj) {
                const int g32 = 8 * u.pn + 4 * bj + wc, hg = g32 % 6;
                const bool rope = lat && hg >= 4;
#pragma unroll
                for (int ai = 0; ai < 2; ++ai)
#pragma unroll
                    for (int m = 0; m < 4; ++m) { const int row = row0 + ai * HALF + m * 16;
                        f32x4 v0 = acc[ai][bj][m][0], v1 = acc[ai][bj][m][1];
                        if (rope) { const int t = (row - 8192) & 1023; const int pos = (hg == 4) ? (t >> 6) : (t & 63);
                            const f32x4 cs = *(const f32x4*)(rtab + pos * 16 + 4 * fq), sn = *(const f32x4*)(rtab + 1024 + pos * 16 + 4 * fq);
                            const f32x4 o1 = v0 * cs - v1 * sn, o2 = v0 * sn + v1 * cs; v0 = o1; v1 = o2; }
                        bf16_t* rowp = Qo + (size_t)row * 1536 + col0 + bj * HALF;
                        u32x2 w0, w1; w0.x = cvt_pk_bf16(v0[0], v0[1]); w0.y = cvt_pk_bf16(v0[2], v0[3]); w1.x = cvt_pk_bf16(v1[0], v1[1]); w1.y = cvt_pk_bf16(v1[2], v1[3]);
                        *(u32x2*)rowp = w0; *(u32x2*)(rowp + 16) = w1; }
            }
        }
    }
};

template <class Epi, class Sched, bool ALIGN_EPI = false, bool SP2 = false>
__device__ __forceinline__ void gemm_phase(PG8_LAS unsigned char* lds, const Gemm g, const Sched& S, const Epi& E) {
    int tid_ = threadIdx.x; asm volatile("" : "+v"(tid_));
    const int tid = tid_, wid = __builtin_amdgcn_readfirstlane(tid >> 6), lane = tid & 63, wr = wid >> 2, wc = wid & 3, fr = lane & 15, fq = lane >> 4;
    const int K = g.K, nt = K / BK;
    unsigned voffA[2], voffB[2];
#pragma unroll
    for (int i = 0; i < 2; ++i) { int R, C; stage_rc(tid * 16 + i * 8192, R, C); const int Rb = Epi::PERM ? ((R & ~31) + perm32(R & 31)) : R;
        voffA[i] = (unsigned)(R * K + C) * 2u; voffB[i] = (unsigned)(Rb * K + C) * 2u; }
    const size_t kstep = (size_t)(BK * 2);
    const size_t hstep = (size_t)HALF * K * 2;
    const size_t tstep = 2 * hstep;
    const unsigned ldsw = (unsigned)wid * 1024u;
    const int aoff = lds_byte(wr * 64 + fr, fq * 8), boff = lds_byte(wc * 32 + fr, fq * 8);
#define PG8_SA(b, h) (((b) * 2 + (h)) * HTB)
#define PG8_SB(b, h) ((4 + (b) * 2 + (h)) * HTB)
#define PG8_STAGE(bufoff, gbase, voff) do { _Pragma("unroll") for (int _i = 0; _i < 2; ++_i) \
        __builtin_amdgcn_global_load_lds((const unsigned*)((const char*)(gbase) + (voff)[_i]), (PG8_LAS unsigned*)(lds + (bufoff) + ldsw + _i * 8192), 16, 0, 0); } while (0)
#define PG8_LDA(dst, b, h) do { _Pragma("unroll") for (int m = 0; m < 4; ++m) _Pragma("unroll") for (int k = 0; k < 2; ++k) dst[m][k] = *(const PG8_LAS bf16x8*)(lds + PG8_SA(b, h) + aoff + m * 2048 + k * 1024); } while (0)
#define PG8_LDB(dst, b, h) do { _Pragma("unroll") for (int n = 0; n < 2; ++n) _Pragma("unroll") for (int k = 0; k < 2; ++k) dst[n][k] = *(const PG8_LAS bf16x8*)(lds + PG8_SB(b, h) + boff + n * 2048 + k * 1024); } while (0)
#define PG8_MMA(ai, bj, At, Bt) do { __builtin_amdgcn_s_setprio(1); _Pragma("unroll") for (int m = 0; m < 4; ++m) _Pragma("unroll") for (int n = 0; n < 2; ++n) _Pragma("unroll") for (int k = 0; k < 2; ++k) \
        acc[ai][bj][m][n] = __builtin_amdgcn_mfma_f32_16x16x32_bf16(Bt[n][k], At[m][k], acc[ai][bj][m][n], 0, 0, 0); __builtin_amdgcn_s_setprio(0); } while (0)
#define PG8_WAIT_V(n) asm volatile("s_waitcnt vmcnt(" #n ")" ::: "memory")
#define PG8_WAIT_L(n) asm volatile("s_waitcnt lgkmcnt(" #n ")" ::: "memory")
#define PG8_BAR __builtin_amdgcn_s_barrier()
#define PG8_SCHED __builtin_amdgcn_sched_barrier(0)
    Unit cur, nxt; int ui = 0;
    if (!S.next(0, cur)) return;
    f32x4 acc[2][2][4][2];
#pragma unroll
    for (int a = 0; a < 2; ++a)
#pragma unroll
        for (int b = 0; b < 2; ++b)
#pragma unroll
            for (int m = 0; m < 4; ++m)
#pragma unroll
                for (int n = 0; n < 2; ++n) acc[a][b][m][n] = (f32x4){0.f, 0.f, 0.f, 0.f};
    bf16x8 At[4][2], B0[2][2], B1[2][2];
    const char* cA = (const char*)g.A + (size_t)cur.pm * tstep; const char* cB = (const char*)g.Bt + (size_t)cur.pn * tstep;
    S.a_ready(cur);
    if constexpr (SP2) {
        PG8_STAGE(PG8_SB(0, 0), cB, voffB); PG8_STAGE(PG8_SB(0, 1), cB + hstep, voffB); PG8_STAGE(PG8_SA(0, 0), cA, voffA); PG8_STAGE(PG8_SA(0, 1), cA + hstep, voffA);
        if (wr == 1) PG8_BAR;
        PG8_WAIT_V(2); PG8_BAR;
        PG8_STAGE(PG8_SB(1, 0), cB + kstep, voffB); PG8_STAGE(PG8_SA(1, 0), cA + kstep, voffA); PG8_STAGE(PG8_SB(1, 1), cB + hstep + kstep, voffB);
        PG8_WAIT_V(6); PG8_BAR;
    } else {
        PG8_STAGE(PG8_SB(0, 0), cB, voffB); PG8_STAGE(PG8_SA(0, 0), cA, voffA); PG8_STAGE(PG8_SB(0, 1), cB + hstep, voffB); PG8_STAGE(PG8_SA(0, 1), cA + hstep, voffA);
        if (wr == 1) PG8_BAR;
        PG8_WAIT_V(4); PG8_BAR;
        PG8_STAGE(PG8_SB(1, 0), cB + kstep, voffB); PG8_STAGE(PG8_SA(1, 0), cA + kstep, voffA); PG8_STAGE(PG8_SB(1, 1), cB + hstep + kstep, voffB);
        PG8_WAIT_V(6); PG8_BAR;
    }
    for (;;) {
        const bool has_next = S.next(ui + 1, nxt);
        const char* nA = has_next ? (const char*)g.A + (size_t)nxt.pm * tstep : cA; const char* nB = has_next ? (const char*)g.Bt + (size_t)nxt.pn * tstep : cB;
        for (int t = 0; t < nt; t += 2) {
            const bool last = (t == nt - 2);
            const char* a1 = cA + (size_t)(t + 1) * kstep;
            const char* a2 = last ? nA : cA + (size_t)(t + 2) * kstep; const char* b2 = last ? nB : cB + (size_t)(t + 2) * kstep;
            const char* a3 = a2 + kstep; const char* b3 = b2 + kstep;
            if (last && has_next) S.a_ready(nxt);
            if constexpr (SP2) {
            PG8_LDB(B0, 0, 0); PG8_LDB(B1, 0, 1); PG8_SCHED; PG8_LDA(At, 0, 0); PG8_STAGE(PG8_SA(1, 1), a1 + hstep, voffA);
            PG8_WAIT_V(8); PG8_WAIT_L(0); PG8_BAR; PG8_MMA(0, 0, At, B0); PG8_MMA(0, 1, At, B1); PG8_BAR; PG8_SCHED;
            PG8_LDA(At, 0, 1); PG8_STAGE(PG8_SB(0, 0), b2, voffB); PG8_STAGE(PG8_SB(0, 1), b2 + hstep, voffB); PG8_STAGE(PG8_SA(0, 0), a2, voffA);
            PG8_WAIT_V(8); PG8_WAIT_L(0); PG8_BAR; PG8_MMA(1, 0, At, B0); PG8_MMA(1, 1, At, B1); PG8_BAR; PG8_SCHED;
            PG8_LDB(B0, 1, 0); PG8_LDB(B1, 1, 1); PG8_SCHED; PG8_LDA(At, 1, 0); PG8_STAGE(PG8_SA(0, 1), a2 + hstep, voffA);
            PG8_WAIT_V(8); PG8_WAIT_L(0); PG8_BAR; PG8_MMA(0, 0, At, B0); PG8_MMA(0, 1, At, B1); PG8_BAR; PG8_SCHED;
            PG8_LDA(At, 1, 1); PG8_STAGE(PG8_SB(1, 0), b3, voffB); PG8_STAGE(PG8_SB(1, 1), b3 + hstep, voffB); PG8_STAGE(PG8_SA(1, 0), a3, voffA);
            PG8_WAIT_V(8); PG8_WAIT_L(0); PG8_BAR; PG8_MMA(1, 0, At, B0); PG8_MMA(1, 1, At, B1); PG8_BAR; PG8_SCHED;
            } else {
            PG8_LDB(B0, 0, 0); PG8_SCHED; PG8_LDA(At, 0, 0); PG8_STAGE(PG8_SA(1, 1), a1 + hstep, voffA);
            PG8_WAIT_L(8); PG8_BAR; PG8_WAIT_L(0); PG8_MMA(0, 0, At, B0); PG8_BAR; PG8_SCHED;
            PG8_LDB(B1, 0, 1); PG8_STAGE(PG8_SB(0, 0), b2, voffB);
            PG8_BAR; PG8_WAIT_L(0); PG8_MMA(0, 1, At, B1); PG8_BAR;
            PG8_LDA(At, 0, 1); PG8_STAGE(PG8_SA(0, 0), a2, voffA);
            PG8_BAR; PG8_WAIT_L(0); PG8_MMA(1, 0, At, B0); PG8_BAR; PG8_SCHED;
            PG8_STAGE(PG8_SB(0, 1), b2 + hstep, voffB);
            PG8_WAIT_V(6); PG8_BAR; PG8_MMA(1, 1, At, B1); PG8_BAR;
            PG8_LDB(B0, 1, 0); PG8_SCHED; PG8_LDA(At, 1, 0); PG8_STAGE(PG8_SA(0, 1), a2 + hstep, voffA);
            PG8_WAIT_L(8); PG8_BAR; PG8_WAIT_L(0); PG8_MMA(0, 0, At, B0); PG8_BAR; PG8_SCHED;
            PG8_LDB(B1, 1, 1); PG8_STAGE(PG8_SB(1, 0), b3, voffB);
            PG8_BAR; PG8_WAIT_L(0); PG8_MMA(0, 1, At, B1); PG8_BAR;
            PG8_LDA(At, 1, 1); PG8_STAGE(PG8_SA(1, 0), a3, voffA);
            PG8_BAR; PG8_WAIT_L(0); PG8_MMA(1, 0, At, B0); PG8_BAR; PG8_SCHED;
            PG8_STAGE(PG8_SB(1, 1), b3 + hstep, voffB);
            PG8_WAIT_V(6); PG8_BAR; PG8_MMA(1, 1, At, B1); PG8_BAR;
            }
        }
        if constexpr (ALIGN_EPI) { if (wr == 0) PG8_BAR; }
        if constexpr (!Epi::AFTER_DRAIN) { E(acc, cur, wr, wc, fr, fq); S.done(cur); }
        if (!has_next) break;
#pragma unroll
        for (int a = 0; a < 2; ++a)
#pragma unroll
            for (int b = 0; b < 2; ++b)
#pragma unroll
                for (int m = 0; m < 4; ++m)
#pragma unroll
                    for (int n = 0; n < 2; ++n) acc[a][b][m][n] = (f32x4){0.f, 0.f, 0.f, 0.f};
        cur = nxt; cA = nA; cB = nB; ++ui;
        if constexpr (ALIGN_EPI) { if (wr == 1) PG8_BAR; }
    }
    PG8_WAIT_V(0);
    if constexpr (!ALIGN_EPI) { if (wr == 0) PG8_BAR; }
    PG8_BAR;
    if constexpr (Epi::AFTER_DRAIN) { E.fused(acc, cur, wr, wc, fr, fq, lds, wid, lane); S.done(cur); }
#undef PG8_SA
#undef PG8_SB
#undef PG8_STAGE
#undef PG8_LDA
#undef PG8_LDB
#undef PG8_MMA
#undef PG8_WAIT_V
#undef PG8_WAIT_L
#undef PG8_BAR
#undef PG8_SCHED
}
}
constexpr int DM = 1024, NPR = 8192  , NSA = 4096  , MTOK = NPR + NSA, DFF = 2816, NUP = 2 * DFF;
constexpr int SEQ_P = 256, SEQ_S = 1024, PAST = 512, KVS = SEQ_S + PAST  , MKV = NPR + 4 * KVS;
constexpr int NADA = 9 * DM;
constexpr float ALPHA_DN = 1.4142135623730951f;
constexpr float LN_EPS = 1e-5f, RMS_EPS = 1e-6f;
constexpr int NQKV = 768;
constexpr int NWAVES = 8;

constexpr size_t MiB = 1u << 20;
constexpr size_t WS_CTL = 0, CTL_ZERO_BYTES = 64 * 1024;
constexpr size_t WS_RTAB = 512 * 1024;
constexpr size_t WS_ADA = 1 * MiB;
constexpr size_t WS_W = 2 * MiB;
constexpr size_t SZ_W13 = (size_t)NUP * DM * 2, SZ_W2 = (size_t)DM * DFF * 2;
constexpr size_t WS_W13 = WS_W;
constexpr size_t SZ_LBLK = 2 * SZ_W13 + 2 * SZ_W2;
constexpr size_t WS_W2 = WS_W13 + 2 * SZ_W13;
__host__ __device__ constexpr size_t ws_w13(int l, int f) { return WS_W13 + (size_t)l * SZ_LBLK + (size_t)f * SZ_W13; }
__host__ __device__ constexpr size_t ws_w2(int l, int f) { return WS_W2 + (size_t)l * SZ_LBLK + (size_t)f * SZ_W2; }
constexpr size_t WS_WIN = WS_W + 2 * SZ_LBLK;
constexpr size_t WS_WOUT = WS_WIN + (size_t)1536 * 1024 * 2;
constexpr size_t WS_POOLW = WS_WOUT + (size_t)1024 * 1024 * 2;
constexpr size_t WS_WDQKV = WS_POOLW + (size_t)4 * 128 * 128 * 2;
constexpr size_t WS_WUQ = WS_WDQKV + (size_t)768 * 1024 * 2;
constexpr size_t WS_WUKV = WS_WUQ + (size_t)1536 * 384 * 2;
constexpr size_t WS_WO = WS_WUKV + (size_t)2048 * 256 * 2;
constexpr size_t WS_WEND = WS_WO + (size_t)1024 * 1024 * 2;
constexpr size_t WS_X = 84 * MiB;
constexpr size_t WS_Z = WS_X + 48 * MiB;
constexpr size_t WS_H = WS_Z + 48 * MiB;
constexpr size_t WS_U = WS_H + 24 * MiB;
constexpr size_t WS_END = WS_U + 66 * MiB;
static_assert(WS_WEND <= WS_X, "weights fit below X");
constexpr size_t WS_G = WS_U, WS_HP = WS_U + 12 * MiB, WS_AB = WS_U + 24 * MiB;
constexpr size_t WS_RAW = WS_Z;
constexpr size_t WS_CQ = WS_H, WS_CKV = WS_H + 9 * MiB, WS_KR = WS_H + 16 * MiB;
constexpr size_t WS_Q = WS_Z;
constexpr size_t WS_KV = WS_U;
constexpr size_t WS_O = WS_W13;
static_assert((size_t)MKV * 2048 * 2 <= 66 * MiB && (size_t)MTOK * 1024 * 2 <= SZ_LBLK, "overlays fit");
constexpr int CW_BAR = 1024;

constexpr int RING_BYTES = 131072;
constexpr int LDSCTL_OFF = RING_BYTES, MISC_OFF = LDSCTL_OFF + 320;
constexpr int LDS_BYTES = 147456;

#define GAS __attribute__((address_space(1)))
#define LAS __attribute__((address_space(3)))
typedef unsigned short bf16;
typedef unsigned v4u __attribute__((ext_vector_type(4)));
typedef unsigned v2u __attribute__((ext_vector_type(2)));
typedef float f32x4 __attribute__((ext_vector_type(4)));
typedef float f32x2 __attribute__((ext_vector_type(2)));
typedef float f32x16 __attribute__((ext_vector_type(16)));
typedef short bf16x8 __attribute__((ext_vector_type(8)));
typedef short s16x4 __attribute__((ext_vector_type(4)));
typedef GAS unsigned gu32;
#define LDS_WAIT() asm volatile("s_waitcnt lgkmcnt(0)" ::: "memory")
#define VM_WAIT() asm volatile("s_waitcnt vmcnt(0)" ::: "memory")
__device__ __forceinline__ unsigned f2bf(float f) { unsigned u = __builtin_bit_cast(unsigned, f); return (u + 0x7fffu + ((u >> 16) & 1u)) >> 16; }
__device__ __forceinline__ unsigned pk2(float lo, float hi) { return f2bf(lo) | (f2bf(hi) << 16); }
__device__ __forceinline__ float bflo(unsigned w) { return __builtin_bit_cast(float, w << 16); }
__device__ __forceinline__ float bfhi(unsigned w) { return __builtin_bit_cast(float, w & 0xffff0000u); }
__device__ __forceinline__ float wave_sum(float v) {
#pragma unroll
    for (int o = 1; o < 64; o <<= 1) v += __shfl_xor(v, o);
    return v;
}
__device__ __forceinline__ float sigmoidf_(float v) { return __builtin_amdgcn_rcpf(1.0f + __builtin_amdgcn_exp2f(-1.4426950408889634f * v)); }

#define XB_TMO      128
#define XB_XCNT(j)  (256  + 64 * (j))
#define XB_XSUB(j)  (1280 + 64 * (j))
#define XB_XGEN(j)  (2304 + 64 * (j))
#define XB_TOP      3328
#define XB_TOPGEN   3392
#define XCD_BAR_WORDS 3456
#define XB_SPIN_CAP (1u << 18)

__device__ __forceinline__ unsigned xb_ld(unsigned* p)              { return __hip_atomic_load(p, __ATOMIC_RELAXED, __HIP_MEMORY_SCOPE_AGENT); }
__device__ __forceinline__ unsigned xb_add(unsigned* p, unsigned v) { return __hip_atomic_fetch_add(p, v, __ATOMIC_RELAXED, __HIP_MEMORY_SCOPE_AGENT); }
__device__ __forceinline__ unsigned xb_xcc_id() { return (unsigned)__builtin_amdgcn_s_getreg((3 << 11) | 20) & 0xFu; }
#define XB_SPIN(cond, bar) do { unsigned _sp = 0; while (cond) { __builtin_amdgcn_s_sleep(1); \
    if ((++_sp & 255u) == 0u) { if (xb_ld(&(bar)[XB_TMO])) break; if (_sp > XB_SPIN_CAP) { atomicAdd(&(bar)[XB_TMO], 1u); break; } } } } while (0)

struct XcdBarrier {
    unsigned* bar; unsigned x;
    volatile LAS unsigned* st;
};

__device__ __forceinline__ XcdBarrier xcd_barrier_post(unsigned* bar, volatile LAS unsigned* st) {
    XcdBarrier b; b.bar = bar; b.x = xb_xcc_id(); b.st = st;
    if (threadIdx.x == 0) (void)xb_add(&bar[XB_XCNT(b.x)], 1u);
    return b;
}
__device__ __forceinline__ void xcd_barrier_complete(unsigned* bar, unsigned x, unsigned& nloc, unsigned& nx) {
    const unsigned G = gridDim.x * gridDim.y * gridDim.z;
    unsigned sum, cnt, mine, sp = 0u;
    for (;;) {
        sum = 0u; cnt = 0u; mine = 0u;
#pragma unroll
        for (unsigned j = 0; j < 16; ++j) { const unsigned c = xb_ld(&bar[XB_XCNT(j)]); sum += c; cnt += (c > 0u) ? 1u : 0u; mine = (j == x) ? c : mine; }
        if (sum == G) break;
        __builtin_amdgcn_s_sleep(1);
        if ((++sp & 255u) == 0u) { if (xb_ld(&bar[XB_TMO])) break; if (sp > XB_SPIN_CAP) { atomicAdd(&bar[XB_TMO], 1u); break; } }
    }
    nloc = mine > 0u ? mine : 1u; nx = cnt > 0u ? cnt : 1u;
}

__device__ __forceinline__ void xcd_barrier(const XcdBarrier& b) {
    asm volatile("s_waitcnt vmcnt(0)" ::: "memory");
    __syncthreads();
    if (threadIdx.x == 0) {
        unsigned* bar = b.bar;
        __builtin_amdgcn_s_waitcnt(0);
        unsigned nloc = b.st[0], nx = b.st[1];
        if (nloc == 0u) { xcd_barrier_complete(bar, b.x, nloc, nx); b.st[0] = nloc; b.st[1] = nx; }
        const unsigned old = xb_add(&bar[XB_XSUB(b.x)], 1u);
        const unsigned gen = old / nloc;
        if (old + 1u == (gen + 1u) * nloc) {
            __builtin_amdgcn_fence(__ATOMIC_RELEASE, "agent");
            asm volatile("s_waitcnt vmcnt(0)" ::: "memory");
            const unsigned og = xb_add(&bar[XB_TOP], 1u);
            const unsigned tg = og / nx;
            if (og + 1u == (tg + 1u) * nx) xb_add(&bar[XB_TOPGEN], 1u);
            else XB_SPIN(xb_ld(&bar[XB_TOPGEN]) == tg, bar);
            __builtin_amdgcn_fence(__ATOMIC_ACQUIRE, "agent");
            xb_add(&bar[XB_XGEN(b.x)], 1u);
            asm volatile("s_waitcnt vmcnt(0)" ::: "memory");
        } else {
            XB_SPIN(xb_ld(&bar[XB_XGEN(b.x)]) == gen, bar);
            __builtin_amdgcn_fence(__ATOMIC_ACQUIRE, "agent");
            asm volatile("s_waitcnt vmcnt(0)" ::: "memory");
        }
    }
    __syncthreads();
}
struct Frame {
    LAS unsigned char* lds;
    volatile LAS unsigned* MISC;
    gu32* ctl;
    int tid, lane, wave, vcu, G;
    const unsigned long long* in;
    float* out; unsigned char* ws;
};
#define FIN(F, i) ((const float*)(const GAS float*)(F).in[i])
enum { I_XP = 0, I_XS, I_CCKV, I_CKR, I_C, I_CCTX, I_WADA, I_BADA, I_LNG, I_LNB, I_W1, I_W3, I_W2, I_CPWIN, I_CONVW, I_CONVB, I_CNG, I_CNB, I_POOLW, I_POOLS, I_CPWOUT,
       I_WDQ, I_QNG, I_WUQ, I_WDKV, I_KVNG, I_WUKV, I_WO };

struct TD { const GAS float* W; bf16* WT; int ldw, K, ncols, blk, stride, off, item0, nitems; };
__device__ __forceinline__ void p0_transpose_item(const TD& d, LAS float* scr, int item, int lane) {
    const int nblk = d.ncols / 32, kb = item / nblk, nb = item % nblk, k0 = 64 * kb, n0 = 32 * nb;
    const int row0 = (n0 / d.blk) * d.stride + d.off + (n0 % d.blk);
    const GAS float* W = d.W; const int ldw = d.ldw, K = d.K;
#pragma unroll 8
    for (int i = 0; i < 32; ++i) { const int kk = 2 * i + (lane >> 5); scr[kk * 33 + (lane & 31)] = W[(size_t)(k0 + kk) * ldw + n0 + (lane & 31)]; }
    LDS_WAIT(); asm volatile("" ::: "memory");
    const int c = lane & 7;
#pragma unroll
    for (int j = 0; j < 4; ++j) { const int n = (lane >> 3) + 8 * j; const LAS float* s = scr + (8 * c) * 33 + n;
        v4u o; o.x = pk2(s[0 * 33], s[1 * 33]); o.y = pk2(s[2 * 33], s[3 * 33]); o.z = pk2(s[4 * 33], s[5 * 33]); o.w = pk2(s[6 * 33], s[7 * 33]);
        *(GAS v4u*)(d.WT + (size_t)(row0 + n) * K + k0 + 8 * c) = o; }
    LDS_WAIT(); asm volatile("" ::: "memory");
}
constexpr int N_TD = 26;
__device__ __forceinline__ void td_add(LAS unsigned long long* tp, LAS int* ti, int& n, int& item0, const float* W, int ldw, int K, int ncols, bf16* WT, int blk, int stride, int off) {
    tp[2 * n] = (unsigned long long)W; tp[2 * n + 1] = (unsigned long long)WT;
    const int nitems = (K / 64) * (ncols / 32);
    ti[8 * n + 0] = ldw; ti[8 * n + 1] = K; ti[8 * n + 2] = ncols; ti[8 * n + 3] = blk; ti[8 * n + 4] = stride; ti[8 * n + 5] = off; ti[8 * n + 6] = item0; ti[8 * n + 7] = nitems;
    item0 += nitems; ++n;
}
__device__ __forceinline__ void p0_build_table(Frame& F, LAS unsigned long long* tp, LAS int* ti) {
    int n = 0, item0 = 0;
    unsigned char* ws = F.ws;
    for (int l = 0; l < 2; ++l) for (int f = 0; f < 2; ++f) {
        const size_t o13 = (size_t)(l * 2 + f) * DM * DFF;
        td_add(tp, ti, n, item0, FIN(F, I_W1) + o13, DFF, DM, DFF, (bf16*)(ws + ws_w13(l, f)), 128, 256, 0);
        td_add(tp, ti, n, item0, FIN(F, I_W3) + o13, DFF, DM, DFF, (bf16*)(ws + ws_w13(l, f)), 128, 256, 128);
        td_add(tp, ti, n, item0, FIN(F, I_W2) + o13, DM, DFF, DM, (bf16*)(ws + ws_w2(l, f)), 1 << 20, 0, 0);
    }
    td_add(tp, ti, n, item0, FIN(F, I_CPWIN), 1536, DM, 512, (bf16*)(ws + WS_WIN), 128, 256, 0);
    td_add(tp, ti, n, item0, FIN(F, I_CPWIN) + 512, 1536, DM, 512, (bf16*)(ws + WS_WIN), 128, 256, 128);
    td_add(tp, ti, n, item0, FIN(F, I_CPWIN) + 1024, 1536, DM, 512, (bf16*)(ws + WS_WIN), 1 << 20, 0, 1024);
    td_add(tp, ti, n, item0, FIN(F, I_CPWOUT), DM, DM, DM, (bf16*)(ws + WS_WOUT), 1 << 20, 0, 0);
    for (int g = 0; g < 4; ++g) td_add(tp, ti, n, item0, FIN(F, I_POOLW) + g * 128 * 128, 128, 128, 128, (bf16*)(ws + WS_POOLW) + g * 128 * 128, 1 << 20, 0, 0);
    td_add(tp, ti, n, item0, FIN(F, I_WDKV), 320, DM, 256, (bf16*)(ws + WS_WDQKV), 1 << 20, 0, 0);
    td_add(tp, ti, n, item0, FIN(F, I_WDQ), 384, DM, 384, (bf16*)(ws + WS_WDQKV), 1 << 20, 0, 256);
    td_add(tp, ti, n, item0, FIN(F, I_WDKV) + 256, 320, DM, 64, (bf16*)(ws + WS_WDQKV), 1 << 20, 0, 640);
    td_add(tp, ti, n, item0, FIN(F, I_WUQ), 1536, 384, 1536, (bf16*)(ws + WS_WUQ), 1 << 20, 0, 0);
    td_add(tp, ti, n, item0, FIN(F, I_WUKV), 2048, 256, 2048, (bf16*)(ws + WS_WUKV), 1 << 20, 0, 0);
    td_add(tp, ti, n, item0, FIN(F, I_WO), DM, DM, DM, (bf16*)(ws + WS_WO), 1 << 20, 0, 0);
    ti[8 * N_TD + 6] = item0;
}
__device__ __forceinline__ void p0_prologue(Frame& F) {
    LAS float* sil = (LAS float*)(F.lds);
    LAS float* red = (LAS float*)(F.lds + 20480);
    LAS unsigned long long* tp = (LAS unsigned long long*)(F.lds + 49152);
    LAS int* ti = (LAS int*)(F.lds + 49152 + 1024);
    LAS float* scr = (LAS float*)(F.lds + 57344 + F.wave * 9216);
    if (F.tid == 0) p0_build_table(F, tp, ti);
    for (int i = F.tid; i < 5 * DM; i += NWAVES * 64) { const int g = i >> 10, d = i & 1023; const float v = (g == 0) ? FIN(F, I_CCTX)[d] : FIN(F, I_C)[(g - 1) * DM + d]; sil[i] = v * sigmoidf_(v); }
    __syncthreads();
    float* ADA = (float*)(F.ws + WS_ADA);
    for (int task = blockIdx.x; task < 144; task += F.G) {
        const int l = task / 72, cg = task % 72, col = cg * 128 + 2 * F.lane;
        const float* wp = FIN(F, I_WADA) + ((size_t)l * DM + F.wave * 128) * NADA + col;
        float a[5][2];
#pragma unroll
        for (int g = 0; g < 5; ++g) { a[g][0] = 0.f; a[g][1] = 0.f; }
#pragma unroll 8
        for (int k = 0; k < 128; ++k) { const f32x2 wv = *(const f32x2*)(wp + (size_t)k * NADA);
#pragma unroll
            for (int g = 0; g < 5; ++g) { const float s = sil[g * DM + F.wave * 128 + k]; a[g][0] += s * wv.x; a[g][1] += s * wv.y; } }
#pragma unroll
        for (int g = 0; g < 5; ++g) { red[(F.wave * 5 + g) * 128 + 2 * F.lane] = a[g][0]; red[(F.wave * 5 + g) * 128 + 2 * F.lane + 1] = a[g][1]; }
        __syncthreads();
        for (int i = F.tid; i < 640; i += NWAVES * 64) { const int g = i >> 7, cc = i & 127; float s = FIN(F, I_BADA)[l * NADA + cg * 128 + cc];
#pragma unroll
            for (int w = 0; w < 8; ++w) s += red[(w * 5 + g) * 128 + cc];
            ADA[(size_t)(l * 5 + g) * NADA + cg * 128 + cc] = s; }
        __syncthreads();
    }
    if (blockIdx.x == F.G - 1) {
        float* rt = (float*)(F.ws + WS_RTAB);
        for (int e = F.tid; e < 1024; e += NWAVES * 64) { const int pos = e >> 4, i = e & 15;
            const double r = 1.0 / sqrt(sqrt(10.0)); double inv = 1.0; for (int q = 0; q < i; ++q) inv *= r;
            const float inv_f = (float)inv;
            double a = (double)((float)pos * inv_f);
            const double TWO_PI = 6.283185307179586476925286766559; const double n = rint(a / TWO_PI); a -= n * TWO_PI;
            const double x2 = a * a; double sn = 1.0, cs = 1.0, ts = 1.0, tc = 1.0;
            for (int q = 1; q <= 13; ++q) { tc *= -x2 / (double)((2 * q - 1) * (2 * q)); ts *= -x2 / (double)((2 * q) * (2 * q + 1)); cs += tc; sn += ts; }
            sn *= a;
            rt[e] = (float)cs; rt[1024 + e] = (float)sn; }
    }
    const int gw = F.vcu * NWAVES + F.wave, NGW = F.G * NWAVES;
    const int total = ti[8 * N_TD + 6];
    int mi = 0;
    for (int it = gw; it < total; it += NGW) {
        while (it >= ti[8 * mi + 6] + ti[8 * mi + 7]) ++mi;
        TD d; d.W = (const GAS float*)tp[2 * mi]; d.WT = (bf16*)tp[2 * mi + 1];
        d.ldw = ti[8 * mi + 0]; d.K = ti[8 * mi + 1]; d.ncols = ti[8 * mi + 2]; d.blk = ti[8 * mi + 3]; d.stride = ti[8 * mi + 4]; d.off = ti[8 * mi + 5]; d.item0 = ti[8 * mi + 6]; d.nitems = ti[8 * mi + 7];
        p0_transpose_item(d, scr, it - d.item0, F.lane);
    }
    { bf16* wd = (bf16*)(F.ws + WS_WDQKV) + (size_t)704 * DM; const int nchunks = 64 * DM * 2 / 16;
      for (int i = blockIdx.x * (NWAVES * 64) + F.tid; i < nchunks; i += F.G * NWAVES * 64) ((GAS v4u*)wd)[i] = (v4u){0u, 0u, 0u, 0u}; }
}

__device__ __forceinline__ int row_group(int row) { return row < NPR ? 0 : 1 + ((row - NPR) >> 10); }

__device__ __forceinline__ void mod0_phase(Frame& F) {
    const int gw = F.vcu * NWAVES + F.wave, NGW = F.G * NWAVES;
    const float* ADA = (const float*)(F.ws + WS_ADA); bf16* H = (bf16*)(F.ws + WS_H);
    for (int row = gw; row < MTOK; row += NGW) {
        const float* xr = row < NPR ? FIN(F, I_XP) + (size_t)row * DM : FIN(F, I_XS) + (size_t)(row - NPR) * DM;
        const float* sh = ADA + (size_t)row_group(row) * NADA; const float* sc = sh + DM;
        GAS unsigned long long* o8 = (GAS unsigned long long*)(H + (size_t)row * DM) + F.lane;
#pragma unroll
        for (int j = 0; j < 4; ++j) { const int c = 4 * F.lane + 256 * j; const f32x4 x = *(const f32x4*)(xr + c), s = *(const f32x4*)(sh + c), k = *(const f32x4*)(sc + c);
            const f32x4 h = x * (k + 1.0f) + s;
            o8[64 * j] = (unsigned long long)pk2(h.x, h.y) | ((unsigned long long)pk2(h.z, h.w) << 32); }
    }
}

__device__ __forceinline__ void ln_phase(Frame& F, const float* Z, float* Xout, const float* g, const float* b, const float* ada_next, int shift_idx, bf16* H) {
    const int gw = F.vcu * NWAVES + F.wave, NGW = F.G * NWAVES;
    f32x4 gg[4], bb[4];
#pragma unroll
    for (int j = 0; j < 4; ++j) { gg[j] = *(const f32x4*)(g + 4 * F.lane + 256 * j); bb[j] = *(const f32x4*)(b + 4 * F.lane + 256 * j); }
    for (int row = gw; row < MTOK; row += NGW) {
        const GAS f32x4* zr = (const GAS f32x4*)(Z + (size_t)row * DM) + F.lane;
        f32x4 v[4]; float s = 0.f;
#pragma unroll
        for (int j = 0; j < 4; ++j) { v[j] = zr[64 * j]; s += (v[j].x + v[j].y) + (v[j].z + v[j].w); }
        const float mean = wave_sum(s) * (1.f / DM); float s2 = 0.f;
#pragma unroll
        for (int j = 0; j < 4; ++j) { v[j] = v[j] - mean; s2 += (v[j].x * v[j].x + v[j].y * v[j].y) + (v[j].z * v[j].z + v[j].w * v[j].w); }
        const float rstd = 1.f / sqrtf(wave_sum(s2) * (1.f / DM) + LN_EPS);
        GAS f32x4* xo = (GAS f32x4*)(Xout + (size_t)row * DM) + F.lane;
#pragma unroll
        for (int j = 0; j < 4; ++j) { v[j] = v[j] * rstd * gg[j] + bb[j]; xo[64 * j] = v[j]; }
        if (H) {
            const float* sh = ada_next + (size_t)row_group(row) * NADA + shift_idx * DM; const float* sc = sh + DM;
            GAS unsigned long long* o8 = (GAS unsigned long long*)(H + (size_t)row * DM) + F.lane;
#pragma unroll
            for (int j = 0; j < 4; ++j) { const int c = 4 * F.lane + 256 * j; const f32x4 sv = *(const f32x4*)(sh + c), kv = *(const f32x4*)(sc + c);
                const f32x4 h = v[j] * (kv + 1.0f) + sv;
                o8[64 * j] = (unsigned long long)pk2(h.x, h.y) | ((unsigned long long)pk2(h.z, h.w) << 32); }
        }
    }
}

__device__ __forceinline__ void convpool_phase(Frame& F) {
    const bf16* G = (const bf16*)(F.ws + WS_G); const bf16* HP = (const bf16*)(F.ws + WS_HP); bf16* AB = (bf16*)(F.ws + WS_AB);
    const bf16* PWT = (const bf16*)(F.ws + WS_POOLW);
    const float* conv_w = FIN(F, I_CONVW); const float* conv_b = FIN(F, I_CONVB); const float* cng = FIN(F, I_CNG); const float* cnb = FIN(F, I_CNB); const float* pscale = FIN(F, I_POOLS);
    const int tid = F.tid, lane = F.lane, wave = F.wave;
    const int cp = tid & 255, th = tid >> 8;
    for (int unit = F.vcu; unit < MTOK / 32; unit += F.G) {
        const int r0 = unit * 32;
        const int seq0 = r0 < NPR ? (r0 & ~(SEQ_P - 1)) : NPR + ((r0 - NPR) & ~(SEQ_S - 1));
        const int slen = r0 < NPR ? SEQ_P : SEQ_S, p0 = r0 - seq0;
        for (int i = tid; i < 62 * 64; i += NWAVES * 64) { const int rr = i >> 6, ch = i & 63; const int p = p0 - 15 + rr;
            v4u v = (v4u){0u, 0u, 0u, 0u}; if (p >= 0 && p < slen) v = *(const GAS v4u*)(G + (size_t)(seq0 + p) * 512 + ch * 8);
            *(LAS v4u*)(F.lds + rr * 1024 + ch * 16) = v; }
        __syncthreads();
        float acc[16][2];
        { float w0[31], w1[31];
#pragma unroll
          for (int k = 0; k < 31; ++k) { const f32x2 wv = *(const f32x2*)(conv_w + k * 512 + 2 * cp); w0[k] = wv.x; w1[k] = wv.y; }
          const f32x2 bv = *(const f32x2*)(conv_b + 2 * cp);
#pragma unroll
          for (int t = 0; t < 16; ++t) { acc[t][0] = bv.x; acc[t][1] = bv.y; }
#pragma unroll
          for (int i = 0; i < 46; ++i) { const unsigned pv = *(const LAS unsigned*)(F.lds + (th * 16 + i) * 1024 + cp * 4); const float x0 = bflo(pv), x1 = bfhi(pv);
#pragma unroll
              for (int t = 0; t < 16; ++t) { const int k = i - t; if (k >= 0 && k < 31) { acc[t][0] += w0[k] * x0; acc[t][1] += w1[k] * x1; } } }
        }
        __syncthreads();
#pragma unroll
        for (int t = 0; t < 16; ++t) *(LAS f32x2*)(F.lds + (th * 16 + t) * 2048 + cp * 8) = (f32x2){acc[t][0], acc[t][1]};
        __syncthreads();
        { f32x4 g0 = *(const f32x4*)(cng + 8 * lane), g1 = *(const f32x4*)(cng + 8 * lane + 4), b0 = *(const f32x4*)(cnb + 8 * lane), b1 = *(const f32x4*)(cnb + 8 * lane + 4);
#pragma unroll
          for (int q = 0; q < 4; ++q) { const int t = wave * 4 + q;
              f32x4 v0 = *(const LAS f32x4*)(F.lds + t * 2048 + lane * 32), v1 = *(const LAS f32x4*)(F.lds + t * 2048 + lane * 32 + 16);
              const float mean = wave_sum((v0.x + v0.y) + (v0.z + v0.w) + (v1.x + v1.y) + (v1.z + v1.w)) * (1.f / 512.f);
              v0 = v0 - mean; v1 = v1 - mean;
              const float var = wave_sum((v0.x * v0.x + v0.y * v0.y) + (v0.z * v0.z + v0.w * v0.w) + (v1.x * v1.x + v1.y * v1.y) + (v1.z * v1.z + v1.w * v1.w)) * (1.f / 512.f);
              const float rstd = 1.f / sqrtf(var + LN_EPS);
              v0 = v0 * rstd * g0 + b0; v1 = v1 * rstd * g1 + b1;
              float y[8] = {v0.x, v0.y, v0.z, v0.w, v1.x, v1.y, v1.z, v1.w};
#pragma unroll
              for (int e = 0; e < 8; ++e) y[e] = y[e] * sigmoidf_(y[e]);
              v4u o; o.x = pk2(y[0], y[1]); o.y = pk2(y[2], y[3]); o.z = pk2(y[4], y[5]); o.w = pk2(y[6], y[7]);
              *(GAS v4u*)(AB + (size_t)(r0 + t) * DM + 8 * lane) = o; }
        }
        __syncthreads();
        for (int i = tid; i < 47 * 64; i += NWAVES * 64) { const int rr = i >> 6, ch = i & 63; const int p = p0 - 8 + rr;
            v4u v = (v4u){0u, 0u, 0u, 0u}; if (p >= 0 && p < slen) v = *(const GAS v4u*)(HP + (size_t)(seq0 + p) * 512 + ch * 8);
            *(LAS v4u*)(F.lds + rr * 1024 + ch * 16) = v; }
        __syncthreads();
        { const int grp = cp >> 6, wnd = 2 << grp, left = wnd >> 1, right = wnd - 1 - left;
#pragma unroll 4
          for (int t = 0; t < 16; ++t) { const int tt = th * 16 + t, pos = p0 + tt;
              const int lo = max(pos - left, 0), hi = min(pos + right, slen - 1);
              float s0 = 0.f, s1 = 0.f;
              for (int p = lo; p <= hi; ++p) { const unsigned pv = *(const LAS unsigned*)(F.lds + (p - p0 + 8) * 1024 + cp * 4); s0 += bflo(pv); s1 += bfhi(pv); }
              const unsigned cv = *(const LAS unsigned*)(F.lds + (tt + 8) * 1024 + cp * 4);
              const float inv = 1.0f / (float)(hi - lo + 1);
              *(LAS unsigned*)(F.lds + 49152 + tt * 1040 + cp * 4) = pk2(s0 * inv - bflo(cv), s1 * inv - bfhi(cv)); }
        }
        __syncthreads();
        { const int grp = wave >> 1, r32 = lane & 31, hi = lane >> 5;
#pragma unroll
          for (int cbi = 0; cbi < 2; ++cbi) { const int cb = 2 * (wave & 1) + cbi; f32x16 o = {};
              const bf16* bp = PWT + ((size_t)(grp * 128 + cb * 32 + r32) * 128 + 8 * hi);
#pragma unroll
              for (int ks = 0; ks < 8; ++ks) { const bf16x8 a = *(const LAS bf16x8*)(F.lds + 49152 + r32 * 1040 + (grp * 128 + 16 * ks + 8 * hi) * 2);
                  const bf16x8 bfr = *(const GAS bf16x8*)(bp + 16 * ks);
                  o = __builtin_amdgcn_mfma_f32_32x32x16_bf16(a, bfr, o, 0, 0, 0); }
              const int col = grp * 128 + cb * 32 + r32; const float ps = pscale[col];
#pragma unroll
              for (int r = 0; r < 16; ++r) { const int row = (r & 3) + 8 * (r >> 2) + 4 * hi; AB[(size_t)(r0 + row) * DM + 512 + col] = (bf16)f2bf(o[r] * ps); } }
        }
        __syncthreads();
    }
}

__device__ __forceinline__ int kv_row(int row) { return row < NPR ? row : NPR + ((row - NPR) >> 10) * KVS + ((row - NPR) & 1023); }
__device__ __forceinline__ void mlanorm_phase(Frame& F) {
    const float* RAW = (const float*)(F.ws + WS_RAW); bf16* CQ = (bf16*)(F.ws + WS_CQ); bf16* CKV = (bf16*)(F.ws + WS_CKV); bf16* KR = (bf16*)(F.ws + WS_KR);
    const float* rtab = (const float*)(F.ws + WS_RTAB);
    float* out_ckv = F.out + (size_t)MTOK * DM; float* out_kr = out_ckv + (size_t)NPR * 256;
    const int gw = F.vcu * NWAVES + F.wave, NGW = F.G * NWAVES, lane = F.lane;
    const f32x4 kvg = *(const f32x4*)(FIN(F, I_KVNG) + 4 * lane);
    f32x2 qg[3];
#pragma unroll
    for (int j = 0; j < 3; ++j) qg[j] = *(const f32x2*)(FIN(F, I_QNG) + 2 * lane + 128 * j);
    for (int task = gw; task < MTOK + 4 * PAST; task += NGW) {
        if (task < MTOK) {
            const int row = task, kr_ = kv_row(row); const float* rp = RAW + (size_t)row * NQKV;
            const f32x4 cv = *(const f32x4*)(rp + 4 * lane);
            f32x2 qv[3];
#pragma unroll
            for (int j = 0; j < 3; ++j) qv[j] = *(const f32x2*)(rp + 256 + 2 * lane + 128 * j);
            const float kr = rp[640 + lane];
            const float rs_c = 1.f / sqrtf(wave_sum((cv.x * cv.x + cv.y * cv.y) + (cv.z * cv.z + cv.w * cv.w)) * (1.f / 256.f) + RMS_EPS);
            float sq = 0.f;
#pragma unroll
            for (int j = 0; j < 3; ++j) sq += qv[j].x * qv[j].x + qv[j].y * qv[j].y;
            const float rs_q = 1.f / sqrtf(wave_sum(sq) * (1.f / 384.f) + RMS_EPS);
            const f32x4 cn = cv * rs_c * kvg;
            *(GAS unsigned long long*)(CKV + (size_t)kr_ * 256 + 4 * lane) = (unsigned long long)pk2(cn.x, cn.y) | ((unsigned long long)pk2(cn.z, cn.w) << 32);
#pragma unroll
            for (int j = 0; j < 3; ++j) { const f32x2 qn = qv[j] * rs_q * qg[j]; *(GAS unsigned*)(CQ + (size_t)row * 384 + 2 * lane + 128 * j) = pk2(qn.x, qn.y); }
            if (row < NPR) {
                *(GAS f32x4*)(out_ckv + (size_t)row * 256 + 4 * lane) = cn;
                out_kr[(size_t)row * 64 + lane] = kr;
                KR[(size_t)kr_ * 64 + lane] = (bf16)f2bf(kr);
            } else {
                const int t = (row - NPR) & 1023, ax = lane >> 5, part = (lane >> 4) & 1, i = lane & 15; const int pos = ax == 0 ? (t >> 6) : (t & 63);
                const float other = __shfl_xor(kr, 16); const float cs = rtab[pos * 16 + i], sn = rtab[1024 + pos * 16 + i];
                const float x1 = part == 0 ? kr : other, x2 = part == 0 ? other : kr;
                const float o = part == 0 ? x1 * cs - x2 * sn : x1 * sn + x2 * cs;
                KR[(size_t)kr_ * 64 + lane] = (bf16)f2bf(o);
            }
        } else {
            const int j = task - MTOK, b = j >> 9, p = j & 511; const int dst = NPR + b * KVS + SEQ_S + p;
            const f32x4 cv = *(const f32x4*)(FIN(F, I_CCKV) + (size_t)j * 256 + 4 * lane);
            *(GAS unsigned long long*)(CKV + (size_t)dst * 256 + 4 * lane) = (unsigned long long)pk2(cv.x, cv.y) | ((unsigned long long)pk2(cv.z, cv.w) << 32);
            KR[(size_t)dst * 64 + lane] = (bf16)f2bf(FIN(F, I_CKR)[(size_t)j * 64 + lane]);
        }
    }
}

namespace att {
constexpr int NW = 8, QBLK = 32, KVBLK = 64;
constexpr int LDQ = 1536, LDK = 2048, LDR = 64, LDO = 1024;
constexpr float SCALE = 0.07216878364870323f;
constexpr float THR = 8.f;
#ifndef ATT_SDEPTH
#define ATT_SDEPTH 1
#endif
constexpr int SDEPTH = ATT_SDEPTH;
constexpr int SHM_V = KVBLK * 128 * 2, SHM_K = KVBLK * 128 * 2, SHM_R = KVBLK * 64 * 2;
constexpr int OFF_V = 0, OFF_K = 2 * SHM_V, OFF_R = OFF_K + 2 * SHM_K, OFF_WS = OFF_R + 2 * SHM_R, ATT_LDS = OFF_WS + NW * 64 * 4;
#define KSWZ(row, colB) ((row) * 256 + ((colB) ^ (((row) & 7) << 4)))
#define RSWZ(row, colB) ((row) * 128 + ((colB) ^ (((row) & 7) << 4)))
#define SBAR() __builtin_amdgcn_sched_barrier(0)
__device__ __forceinline__ int crow(int r, int hi) { return (r & 3) + 8 * (r >> 2) + 4 * hi; }
__device__ __forceinline__ unsigned cvtpk(float lo, float hi) { unsigned r; asm volatile("v_cvt_pk_bf16_f32 %0, %1, %2" : "=v"(r) : "v"(lo), "v"(hi)); return r; }

__device__ __forceinline__ void partialSM(f32x16& p0, f32x16& p1, float& m_reg, float& mn, float& alpha) {
  constexpr float C = SCALE * 1.4426950408889634f;
  float pmax = p0[0];
#pragma unroll
  for (int r = 1; r < 16; ++r) pmax = fmaxf(pmax, p0[r]);
#pragma unroll
  for (int r = 0; r < 16; ++r) pmax = fmaxf(pmax, p1[r]);
  { auto rr = __builtin_amdgcn_permlane32_swap(__float_as_uint(pmax), __float_as_uint(pmax), false, false);
    pmax = fmaxf(__uint_as_float(rr[0]), __uint_as_float(rr[1])); }
  if (__builtin_expect(__all(pmax - m_reg <= THR / SCALE), 1)) { mn = m_reg; alpha = 1.f; }
  else { mn = fmaxf(m_reg, pmax); alpha = __builtin_amdgcn_exp2f((m_reg - mn) * C); m_reg = mn; }
  float mnC = -mn * C;
#pragma unroll
  for (int r = 0; r < 16; ++r) p0[r] = fmaf(p0[r], C, mnC);
#pragma unroll
  for (int r = 0; r < 16; ++r) p1[r] = fmaf(p1[r], C, mnC);
#pragma unroll
  for (int r = 0; r < 16; ++r) p0[r] = __builtin_amdgcn_exp2f(p0[r]);
}
__device__ __forceinline__ void finishSM(f32x16& p0, f32x16& p1, float alpha, float& l_reg, bf16x8& pa0, bf16x8& pa1, bf16x8& pa2, bf16x8& pa3) {
#pragma unroll
  for (int r = 0; r < 16; ++r) p1[r] = __builtin_amdgcn_exp2f(p1[r]);
  float ps = 0;
#pragma unroll
  for (int r = 0; r < 16; ++r) ps += p0[r];
#pragma unroll
  for (int r = 0; r < 16; ++r) ps += p1[r];
  { auto rr = __builtin_amdgcn_permlane32_swap(__float_as_uint(ps), __float_as_uint(ps), false, false);
    ps = __uint_as_float(rr[0]) + __uint_as_float(rr[1]); }
  l_reg = l_reg * alpha + ps;
#define PK4(P, BASE, OUT) do { unsigned a0 = cvtpk(P[BASE + 0], P[BASE + 1]), a1 = cvtpk(P[BASE + 2], P[BASE + 3]);   \
    unsigned b0 = cvtpk(P[BASE + 4], P[BASE + 5]), b1 = cvtpk(P[BASE + 6], P[BASE + 7]);                              \
    auto r0 = __builtin_amdgcn_permlane32_swap(a0, b0, false, false); auto r1 = __builtin_amdgcn_permlane32_swap(a1, b1, false, false); \
    v4u w = {r0[0], r1[0], r0[1], r1[1]}; OUT = *reinterpret_cast<bf16x8*>(&w); } while (0)
  PK4(p0, 0, pa0); PK4(p0, 8, pa1); PK4(p1, 0, pa2); PK4(p1, 8, pa3);
#undef PK4
}
__device__ __forceinline__ void qkt(f32x16& p0, f32x16& p1, const LAS char* Ks, const LAS char* Rs, const bf16x8* qr, int r32, int hi) {
  p0 = f32x16{}; p1 = f32x16{};
#pragma unroll
  for (int d0 = 0; d0 < 8; ++d0) { const int cb = (d0 * 16 + hi * 8) * 2;
    const bf16x8 b0 = *reinterpret_cast<const LAS bf16x8*>(Ks + KSWZ(r32, cb));
    const bf16x8 b1 = *reinterpret_cast<const LAS bf16x8*>(Ks + KSWZ(32 + r32, cb));
    p0 = __builtin_amdgcn_mfma_f32_32x32x16_bf16(b0, qr[d0], p0, 0, 0, 0);
    p1 = __builtin_amdgcn_mfma_f32_32x32x16_bf16(b1, qr[d0], p1, 0, 0, 0); }
#pragma unroll
  for (int d0 = 0; d0 < 4; ++d0) { const int cb = (d0 * 16 + hi * 8) * 2;
    const bf16x8 b0 = *reinterpret_cast<const LAS bf16x8*>(Rs + RSWZ(r32, cb));
    const bf16x8 b1 = *reinterpret_cast<const LAS bf16x8*>(Rs + RSWZ(32 + r32, cb));
    p0 = __builtin_amdgcn_mfma_f32_32x32x16_bf16(b0, qr[8 + d0], p0, 0, 0, 0);
    p1 = __builtin_amdgcn_mfma_f32_32x32x16_bf16(b1, qr[8 + d0], p1, 0, 0, 0); }
}
__device__ __forceinline__ int v_st(int k, int c) { const int kk = (k & ~0xC) | ((k & 4) << 1) | ((k & 8) >> 1); return ((kk >> 3) * 4 + (c >> 5)) * 512 + ((kk & 7) * 32 + (c & 31)) * 2; }
__device__ __forceinline__ int v_rd_base(int lane) { return ((lane & 3) << 3) | (((lane >> 2) & 3) << 6) | (((lane >> 4) & 1) << 5) | (((lane >> 5) & 1) << 8); }
constexpr int v_rd_off(int d0, int ks, int half) { return d0 * 512 + ks * 4096 + half * 2048; }
template <int OFF> __device__ __forceinline__ s16x4 tr_read(int vb) {
  s16x4 r; asm volatile("ds_read_b64_tr_b16 %0, %1 offset:%2" : "=&v"(r) : "v"(vb), "i"(OFF) : "memory"); return r;
}
template <int D0> __device__ __forceinline__ void pv_one(f32x16& od, int vb, bf16x8 pa0, bf16x8 pa1, bf16x8 pa2, bf16x8 pa3) {
  const s16x4 l0 = tr_read<v_rd_off(D0, 0, 0)>(vb), h0 = tr_read<v_rd_off(D0, 0, 1)>(vb), l1 = tr_read<v_rd_off(D0, 1, 0)>(vb), h1 = tr_read<v_rd_off(D0, 1, 1)>(vb);
  const s16x4 l2 = tr_read<v_rd_off(D0, 2, 0)>(vb), h2 = tr_read<v_rd_off(D0, 2, 1)>(vb), l3 = tr_read<v_rd_off(D0, 3, 0)>(vb), h3 = tr_read<v_rd_off(D0, 3, 1)>(vb);
  asm volatile("s_waitcnt lgkmcnt(0)" ::: "memory"); SBAR();
#define PK(L, H) (bf16x8){L[0], L[1], L[2], L[3], H[0], H[1], H[2], H[3]}
  od = __builtin_amdgcn_mfma_f32_32x32x16_bf16(pa0, PK(l0, h0), od, 0, 0, 0);
  od = __builtin_amdgcn_mfma_f32_32x32x16_bf16(pa1, PK(l1, h1), od, 0, 0, 0);
  od = __builtin_amdgcn_mfma_f32_32x32x16_bf16(pa2, PK(l2, h2), od, 0, 0, 0);
  od = __builtin_amdgcn_mfma_f32_32x32x16_bf16(pa3, PK(l3, h3), od, 0, 0, 0);
#undef PK
}
__device__ __forceinline__ void pv_d0(f32x16* o, int vb, bf16x8 pa0, bf16x8 pa1, bf16x8 pa2, bf16x8 pa3) {
  pv_one<0>(o[0], vb, pa0, pa1, pa2, pa3); pv_one<1>(o[1], vb, pa0, pa1, pa2, pa3); pv_one<2>(o[2], vb, pa0, pa1, pa2, pa3); pv_one<3>(o[3], vb, pa0, pa1, pa2, pa3);
}

__device__ __forceinline__ void attn_unit(const bf16* __restrict__ Qb, const bf16* __restrict__ Kh, const bf16* __restrict__ Vh, const bf16* __restrict__ Rh,
                                          bf16* __restrict__ Ob, int seq, LAS char* lds) {
  int tid_ = threadIdx.x; asm volatile("" : "+v"(tid_));
  const int tid = tid_, wid = tid >> 6, lane = tid & 63, r32 = lane & 31, hi = lane >> 5;
  LAS char* V_lds = lds + OFF_V; LAS char* K_lds = lds + OFF_K; LAS char* R_lds = lds + OFF_R;
  LAS float* ws = (LAS float*)(lds + OFF_WS) + wid * 64; LAS float* li_l = ws; LAS float* al_l = ws + 32;
  float m_reg = -1e30f, l_reg = 0; f32x16 o[4] = {}; bf16x8 qr[12];
  const bf16* Qw = Qb + (long)(wid * QBLK + r32) * LDQ + hi * 8;
#pragma unroll
  for (int d0 = 0; d0 < 12; ++d0) qr[d0] = *reinterpret_cast<const bf16x8*>(Qw + d0 * 16);
  const int sr = tid >> 4, sc = (tid & 15) * 8, vst0 = v_st(sr, sc), vst1 = v_st(32 + sr, sc);
  const int rr_ = tid >> 3, rc = (tid & 7) * 8;
  const int vb0 = (int)(uintptr_t)V_lds + v_rd_base(lane);
  struct { bf16x8 vs0, vs1, ks0, ks1, rs; } sr_[SDEPTH];
#define SLOAD(i, k0) do { sr_[i].vs0 = *reinterpret_cast<const bf16x8*>(&Vh[(long)((k0) + sr) * LDK + sc]); sr_[i].vs1 = *reinterpret_cast<const bf16x8*>(&Vh[(long)((k0) + 32 + sr) * LDK + sc]); \
    sr_[i].ks0 = *reinterpret_cast<const bf16x8*>(&Kh[(long)((k0) + sr) * LDK + sc]); sr_[i].ks1 = *reinterpret_cast<const bf16x8*>(&Kh[(long)((k0) + 32 + sr) * LDK + sc]); \
    sr_[i].rs = *reinterpret_cast<const bf16x8*>(&Rh[(long)((k0) + rr_) * LDR + rc]); } while (0)
#define SWRITE(b, i) do { *(LAS bf16x8*)(V_lds + (b) * SHM_V + vst0) = sr_[i].vs0;          \
    *(LAS bf16x8*)(V_lds + (b) * SHM_V + vst1) = sr_[i].vs1; const int kc = sc * 2;               \
    *(LAS bf16x8*)(K_lds + (b) * SHM_K + KSWZ(sr, kc)) = sr_[i].ks0;                       \
    *(LAS bf16x8*)(K_lds + (b) * SHM_K + KSWZ(32 + sr, kc)) = sr_[i].ks1;                  \
    *(LAS bf16x8*)(R_lds + (b) * SHM_R + RSWZ(rr_, rc * 2)) = sr_[i].rs; } while (0)
#define SWAIT() do { if constexpr (SDEPTH == 2) asm volatile("s_waitcnt vmcnt(5)" ::: "memory"); else asm volatile("s_waitcnt vmcnt(0)" ::: "memory"); } while (0)
#define RESC(a) do { if (__any((a) < 1.f)) { if (hi == 0) al_l[r32] = (a); asm volatile("s_waitcnt lgkmcnt(0)" ::: "memory"); \
    _Pragma("unroll") for (int d = 0; d < 4; ++d) _Pragma("unroll") for (int r = 0; r < 16; ++r) o[d][r] *= al_l[crow(r, hi)]; } } while (0)
  f32x16 pA0, pA1, pB0, pB1; float mnA, mnB, alA, alB; bf16x8 pa0, pa1, pa2, pa3; const int NT = seq / KVBLK;
  constexpr int SE = 0, SO = SDEPTH - 1;
  SLOAD(SE, 0); asm volatile("s_waitcnt vmcnt(0)" ::: "memory"); SWRITE(0, SE); __syncthreads();
  qkt(pA0, pA1, K_lds, R_lds, qr, r32, hi); partialSM(pA0, pA1, m_reg, mnA, alA);
  SLOAD(SO, KVBLK); if constexpr (SDEPTH == 2) { if (2 < NT) SLOAD(SE, 2 * KVBLK); }
  SWAIT(); SWRITE(1, SO); __syncthreads();
  for (int j = 1; j + 1 < NT; j += 2) {
    SBAR(); qkt(pB0, pB1, K_lds + SHM_K, R_lds + SHM_R, qr, r32, hi);
    finishSM(pA0, pA1, alA, l_reg, pa0, pa1, pa2, pa3); SBAR();
    SLOAD(SO, (j + SDEPTH) * KVBLK); SBAR();
    pv_d0(o, vb0, pa0, pa1, pa2, pa3); partialSM(pB0, pB1, m_reg, mnB, alB);
    __syncthreads(); SWAIT(); SWRITE(0, SE);
    RESC(alB); __syncthreads();
    SBAR(); qkt(pA0, pA1, K_lds, R_lds, qr, r32, hi);
    finishSM(pB0, pB1, alB, l_reg, pa0, pa1, pa2, pa3); SBAR();
    if (SDEPTH == 1 || j + 3 < NT) SLOAD(SE, (j + 1 + SDEPTH) * KVBLK); SBAR();
    pv_d0(o, vb0 + SHM_V, pa0, pa1, pa2, pa3); partialSM(pA0, pA1, m_reg, mnA, alA);
    __syncthreads(); SWAIT(); SWRITE(1, SO);
    RESC(alA); __syncthreads();
  }
  SBAR(); qkt(pB0, pB1, K_lds + SHM_K, R_lds + SHM_R, qr, r32, hi);
  finishSM(pA0, pA1, alA, l_reg, pa0, pa1, pa2, pa3); SBAR();
  pv_d0(o, vb0, pa0, pa1, pa2, pa3); partialSM(pB0, pB1, m_reg, mnB, alB);
  __syncthreads(); RESC(alB);
  finishSM(pB0, pB1, alB, l_reg, pa0, pa1, pa2, pa3); SBAR();
  pv_d0(o, vb0 + SHM_V, pa0, pa1, pa2, pa3);
  if (hi == 0) li_l[r32] = l_reg; asm volatile("s_waitcnt lgkmcnt(0)" ::: "memory");
  float rli[16];
#pragma unroll
  for (int r = 0; r < 16; ++r) rli[r] = __builtin_amdgcn_rcpf(li_l[crow(r, hi)]);
  bf16* Ow = Ob + (long)(wid * QBLK) * LDO;
#pragma unroll
  for (int r = 0; r < 16; ++r) { const int orow = crow(r, hi);
#pragma unroll
    for (int d0 = 0; d0 < 4; ++d0) Ow[(long)orow * LDO + d0 * 32 + r32] = (bf16)f2bf(o[d0][r] * rli[r]); }
  __syncthreads();
#undef SLOAD
#undef SWRITE
#undef SWAIT
#undef RESC
}
#undef KSWZ
#undef RSWZ
#undef SBAR
}

__device__ __forceinline__ void attn_phase(Frame& F) {
    const bf16* Q = (const bf16*)(F.ws + WS_Q); const bf16* KV = (const bf16*)(F.ws + WS_KV); const bf16* KR = (const bf16*)(F.ws + WS_KR); bf16* O = (bf16*)(F.ws + WS_O);
    for (int i = 0;; ++i) {
        int u;
        if (F.G >= 256) { if (F.vcu < 128) u = (i == 0) ? F.vcu : -1; else if (F.vcu < 256) u = (i < 2) ? 128 + 2 * (F.vcu - 128) + i : -1; else u = -1; }
        else { u = F.vcu + i * F.G; if (u >= 384) u = -1; }
        if (u < 0) break;
        int qrow, kvrow, h, nk;
        if (u < 128) { const int b = u >> 5; h = (u >> 2) & 7; qrow = NPR + b * SEQ_S + (u & 3) * 256; kvrow = NPR + b * KVS; nk = KVS; }
        else { const int b = (u - 128) >> 3; h = (u - 128) & 7; qrow = b * SEQ_P; kvrow = b * SEQ_P; nk = SEQ_P; }
        att::attn_unit(Q + (size_t)qrow * 1536 + h * 192, KV + (size_t)kvrow * 2048 + h * 256, KV + (size_t)kvrow * 2048 + h * 256 + 128, KR + (size_t)kvrow * 64,
                       O + (size_t)qrow * 1024 + h * 128, nk, (LAS char*)F.lds);
    }
}

constexpr int N_PHASES = 24;
#ifndef MK_PHMASK
#define MK_PHMASK 0xFFFF
#endif
#define EN(k) (((MK_PHMASK) >> (k)) & 1)
struct Args { unsigned long long in[28]; unsigned long long out, ws; int ph_lo, ph_hi; };
static_assert(sizeof(Args) == 28 * 8 + 8 + 8 + 8, "Args has no padding");

__device__ __forceinline__ int opaque_i(int v) { asm volatile("" : "+s"(v)); return v; }
__device__ __forceinline__ void run_up(Frame& F, int l, int f) {
    unsigned char* ws = F.ws;
    pg8::Gemm g{(const bf16*)(ws + WS_H), (const bf16*)(ws + ws_w13(l, f)), MTOK, opaque_i(NUP), opaque_i(DM)}; pg8::StaticOrder S; S.init(MTOK, g.N, F.G, (int)blockIdx.x);
    pg8::EpiB E{0, (bf16*)(ws + WS_U), nullptr, DFF, 0};
    pg8::gemm_phase<pg8::EpiB, pg8::StaticOrder, true, true>(F.lds, g, S, E);
}
__device__ __forceinline__ void run_resid(Frame& F, int l, int f, int kind, bool first) {
    unsigned char* ws = F.ws;
    const bf16* A; const bf16* Bt; int K; int gidx; float wgt;
    if (kind == 0) { A = (const bf16*)(ws + WS_U); Bt = (const bf16*)(ws + ws_w2(l, f)); K = DFF; gidx = f == 0 ? 2 : 8; wgt = 0.5f; }
    else if (kind == 1) { A = (const bf16*)(ws + WS_AB); Bt = (const bf16*)(ws + WS_WOUT); K = DM; gidx = 5; wgt = 1.0f; }
    else { A = (const bf16*)(ws + WS_O); Bt = (const bf16*)(ws + WS_WO); K = DM; gidx = 5; wgt = 1.0f; }
    const float* X = (const float*)(ws + WS_X);
    pg8::Gemm g{A, Bt, MTOK, opaque_i(DM), opaque_i(K)}; pg8::StaticOrder S; S.init(MTOK, g.N, F.G, (int)blockIdx.x);
    pg8::EpiF E{0, (float*)(ws + WS_Z), DM, first ? FIN(F, I_XP) : X, first ? FIN(F, I_XS) : X + (size_t)NPR * DM, (const float*)(ws + WS_ADA) + (size_t)l * 5 * NADA, gidx, wgt, ALPHA_DN, nullptr, nullptr};
    pg8::gemm_phase<pg8::EpiF, pg8::StaticOrder, true, true>(F.lds, g, S, E);
}
__device__ __forceinline__ void run_ln(Frame& F, int l, int s, bool last) {
    unsigned char* ws = F.ws;
    const float* gp = FIN(F, I_LNG) + (size_t)(l * 3 + s) * DM; const float* bp = FIN(F, I_LNB) + (size_t)(l * 3 + s) * DM;
    const int nl = (s == 2) ? l + 1 : l; const int sidx = (s == 0) ? 3 : (s == 1 ? 6 : 0);
    ln_phase(F, (const float*)(ws + WS_Z), last ? F.out : (float*)(ws + WS_X), gp, bp, (const float*)(ws + WS_ADA) + (size_t)(last ? 0 : nl) * 5 * NADA, sidx, last ? nullptr : (bf16*)(ws + WS_H));
}
__device__ __forceinline__ void run_win(Frame& F) {
    unsigned char* ws = F.ws;
    pg8::Gemm g{(const bf16*)(ws + WS_H), (const bf16*)(ws + WS_WIN), MTOK, opaque_i(1536), opaque_i(DM)}; pg8::StaticOrder S; S.init(MTOK, g.N, F.G, (int)blockIdx.x);
    pg8::EpiB E{1, (bf16*)(ws + WS_G), (bf16*)(ws + WS_HP), 512, 512};
    pg8::gemm_phase<pg8::EpiB, pg8::StaticOrder, true, true>(F.lds, g, S, E);
}
__device__ __forceinline__ void run_dqkv(Frame& F) {
    unsigned char* ws = F.ws;
    pg8::Gemm g{(const bf16*)(ws + WS_H), (const bf16*)(ws + WS_WDQKV), MTOK, opaque_i(NQKV), opaque_i(DM)}; pg8::StaticOrder S; S.init(MTOK, g.N, F.G, (int)blockIdx.x);
    pg8::EpiF E{1, (float*)(ws + WS_RAW), NQKV, nullptr, nullptr, nullptr, 0, 0.f, 0.f, nullptr, nullptr};
    pg8::gemm_phase<pg8::EpiF, pg8::StaticOrder, true, true>(F.lds, g, S, E);
}
__device__ __forceinline__ void run_uq(Frame& F) {
    unsigned char* ws = F.ws;
    pg8::Gemm g{(const bf16*)(ws + WS_CQ), (const bf16*)(ws + WS_WUQ), MTOK, opaque_i(1536), opaque_i(384)}; pg8::StaticOrder S; S.init(MTOK, g.N, F.G, (int)blockIdx.x);
    pg8::EpiF E{2, nullptr, 0, nullptr, nullptr, nullptr, 0, 0.f, 0.f, (bf16*)(ws + WS_Q), (const float*)(ws + WS_RTAB)};
    pg8::gemm_phase<pg8::EpiF, pg8::StaticOrder, true, true>(F.lds, g, S, E);
}
__device__ __forceinline__ void run_ukv(Frame& F) {
    unsigned char* ws = F.ws;
    pg8::Gemm g{(const bf16*)(ws + WS_CKV), (const bf16*)(ws + WS_WUKV), MKV, opaque_i(2048), opaque_i(256)}; pg8::StaticOrder S; S.init(MKV, g.N, F.G, (int)blockIdx.x);
    pg8::EpiB E{2, (bf16*)(ws + WS_KV), nullptr, 2048, 0};
    pg8::gemm_phase<pg8::EpiB, pg8::StaticOrder, true, true>(F.lds, g, S, E);
}

__global__ void __launch_bounds__(NWAVES * 64, 2) fwd_megakernel(Args args) {
    extern __shared__ __attribute__((aligned(16))) unsigned char lds[];
    Frame F;
    F.lds = (LAS unsigned char*)lds;
    F.MISC = (volatile LAS unsigned*)(F.lds + MISC_OFF);
    F.tid = threadIdx.x; F.lane = F.tid & 63; F.wave = __builtin_amdgcn_readfirstlane(F.tid >> 6);
    F.G = gridDim.x; { const int bx = blockIdx.x; F.vcu = (F.G % 8 == 0) ? (bx % 8) * (F.G / 8) + bx / 8 : bx; }
    F.in = args.in; F.out = (float*)(GAS float*)args.out; F.ws = (unsigned char*)(GAS unsigned char*)args.ws;
    F.ctl = (gu32*)((GAS unsigned char*)args.ws + WS_CTL);
    for (int u = F.tid; u < (LDS_BYTES - LDSCTL_OFF) / 4; u += NWAVES * 64) ((LAS unsigned*)(F.lds + LDSCTL_OFF))[u] = 0u;
    __syncthreads();
    const int lo = args.ph_lo, hi = args.ph_hi;
    XcdBarrier bar; bar.bar = (unsigned*)(F.ctl + CW_BAR); bar.x = 0; bar.st = nullptr;
    if (hi - lo > 1) bar = xcd_barrier_post((unsigned*)(F.ctl + CW_BAR), F.MISC + 8);

#define PHASE(k, en, body) do { if (lo <= (k) && (k) < hi) { if constexpr (EN(en)) { \
        int t_ = threadIdx.x; asm volatile("" : "+v"(t_)); F.tid = t_; F.lane = t_ & 63; F.wave = __builtin_amdgcn_readfirstlane(t_ >> 6); \
        GAS unsigned char* w_ = (GAS unsigned char*)args.ws; asm volatile("" : "+s"(w_)); F.ws = (unsigned char*)w_; body; } \
        if ((k) + 1 < hi) xcd_barrier(bar); } } while (0)
    PHASE(0, 0, p0_prologue(F));
    PHASE(1, 1, mod0_phase(F));
    PHASE(2, 2, run_up(F, 0, 0));
    PHASE(3, 3, run_resid(F, 0, 0, 0, true));
    PHASE(4, 4, run_ln(F, 0, 0, false));
    PHASE(5, 5, run_win(F));
    PHASE(6, 6, convpool_phase(F));
    PHASE(7, 3, run_resid(F, 0, 0, 1, false));
    PHASE(8, 4, run_ln(F, 0, 1, false));
    PHASE(9, 2, run_up(F, 0, 1));
    PHASE(10, 3, run_resid(F, 0, 1, 0, false));
    PHASE(11, 4, run_ln(F, 0, 2, false));
    PHASE(12, 2, run_up(F, 1, 0));
    PHASE(13, 3, run_resid(F, 1, 0, 0, false));
    PHASE(14, 4, run_ln(F, 1, 0, false));
    PHASE(15, 7, run_dqkv(F));
    PHASE(16, 8, mlanorm_phase(F));
    PHASE(17, 9, { run_uq(F); run_ukv(F); });
    PHASE(18, 10, attn_phase(F));
    PHASE(19, 3, run_resid(F, 1, 0, 2, false));
    PHASE(20, 4, run_ln(F, 1, 1, false));
    PHASE(21, 2, run_up(F, 1, 1));
    PHASE(22, 3, run_resid(F, 1, 1, 0, false));
    PHASE(23, 4, run_ln(F, 1, 2, true));
#undef PHASE
}

extern "C" void kernel_launch(void* const* d_in, const int* in_sizes, int n_in, void* d_out, int out_size, void* d_ws, size_t ws_size, hipStream_t stream) {
    static int grid = 0;
    if (grid == 0) {
        const int want_out = MTOK * DM + NPR * 256 + NPR * 64;
        if (n_in != 28 || in_sizes[0] != NPR * DM || in_sizes[1] != NSA * DM || out_size != want_out || ws_size < WS_END) {
            fprintf(stderr, "kernel_launch: shape mismatch: n_in %d in0 %d in1 %d out %d (want %d) ws %zu (need %zu); nothing launched\n", n_in, n_in > 0 ? in_sizes[0] : -1, n_in > 1 ? in_sizes[1] : -1, out_size, want_out, ws_size, (size_t)WS_END);
            grid = -1; return; }
        int dev = 0, cus = 0, per_cu = 0;
        if (hipGetDevice(&dev) != hipSuccess || hipDeviceGetAttribute(&cus, hipDeviceAttributeMultiprocessorCount, dev) != hipSuccess) { fprintf(stderr, "kernel_launch: device query failed\n"); grid = -1; return; }
        if (hipFuncSetAttribute((const void*)fwd_megakernel, hipFuncAttributeMaxDynamicSharedMemorySize, LDS_BYTES) != hipSuccess) { fprintf(stderr, "kernel_launch: hipFuncSetAttribute failed\n"); grid = -1; return; }
        if (hipOccupancyMaxActiveBlocksPerMultiprocessor(&per_cu, (const void*)fwd_megakernel, NWAVES * 64, LDS_BYTES) != hipSuccess || per_cu < 1) {
            fprintf(stderr, "kernel_launch: occupancy query reports %d workgroups per CU; nothing launched\n", per_cu); (void)hipGetLastError(); grid = -1; return; }
        grid = cus;
        if (grid > 256) grid = 256;
        grid &= ~7;
    }
    if (grid <= 0) return;
    if (hipMemsetAsync((char*)d_ws + WS_CTL, 0, CTL_ZERO_BYTES, stream) != hipSuccess) { fprintf(stderr, "kernel_launch: hipMemsetAsync failed\n"); return; }
    Args a{};
    for (int i = 0; i < 28; ++i) a.in[i] = (unsigned long long)(uintptr_t)d_in[i];
    a.out = (unsigned long long)(uintptr_t)d_out; a.ws = (unsigned long long)(uintptr_t)d_ws;
#if MK_MULTI
    for (int ph = 0; ph < N_PHASES; ++ph) {
        a.ph_lo = ph; a.ph_hi = ph + 1;
        hipLaunchKernelGGL(fwd_megakernel, dim3(grid), dim3(NWAVES * 64), LDS_BYTES, stream, a);
    }
#else
    a.ph_lo = 0; a.ph_hi = N_PHASES;
    void* kargs[] = {&a};
    hipError_t e = hipLaunchCooperativeKernel((const void*)fwd_megakernel, dim3(grid), dim3(NWAVES * 64), kargs, LDS_BYTES, stream);
    if (e != hipSuccess) fprintf(stderr, "kernel_launch: cooperative launch failed: %s (grid %d)\n", hipGetErrorString(e), grid);
#endif
    const hipError_t le = hipPeekAtLastError();
    if (le != hipSuccess) fprintf(stderr, "kernel_launch: launch failed: %s\n", hipGetErrorName(le));
}
```
